# Optimizing an MI355X kernel written in HIP

```python
import jax, jax.numpy as jnp
from jax import lax
import numpy as np

D_MODEL = 1024
BATCH = 8
SEQ = 4096
DEPTH = 1

GRID_W = 64
N_Q_HEADS = 8
N_KV_HEADS = 2
Q_PER_KV = N_Q_HEADS // N_KV_HEADS
HEAD_DIM = 64
AXIAL_DIM = HEAD_DIM // 2
ROPE_THETA = 10000.0
Q_BLOCK = 128
GLA_HEADS = 4
GLA_DK = 64
GLA_DV = 128
GATE_RANK = 16
GATE_TAU = 16.0
GLA_CHUNK = 16
ATTN_WIDTH = N_Q_HEADS * HEAD_DIM
GLA_WIDTH = GLA_HEADS * GLA_DV
MIX_WIDTH = ATTN_WIDTH + GLA_WIDTH
D_FF = -((-8 * D_MODEL) // (3 * 256)) * 256
PROJ_SIZES = (ATTN_WIDTH, N_KV_HEADS * HEAD_DIM, N_KV_HEADS * HEAD_DIM,
              GLA_HEADS * GLA_DK, GLA_HEADS * GLA_DK, GLA_WIDTH, GLA_WIDTH, GATE_RANK, GATE_RANK)
PROJ_WIDTH = sum(PROJ_SIZES)
PROJ_SPLITS = tuple(np.cumsum(PROJ_SIZES)[:-1].tolist())
DEEPNORM_ALPHA = (2 * DEPTH) ** 0.25
DEEPNORM_BETA = (8 * DEPTH) ** -0.25
LN_EPS = 1e-5
RMS_EPS = 1e-6

kernel_name = "hybrid_gqa_gla_deepnorm_encoder_block"


def layer_norm(x, g, b):
    xf = x.astype(jnp.float32)
    mu = jnp.mean(xf, -1, keepdims=True)
    var = jnp.mean(jnp.square(xf - mu), -1, keepdims=True)
    return ((xf - mu) * lax.rsqrt(var + LN_EPS) * g + b).astype(x.dtype)


def rms_norm(x, g):
    xf = x.astype(jnp.float32)
    return (xf * lax.rsqrt(jnp.mean(jnp.square(xf), -1, keepdims=True) + RMS_EPS) * g).astype(x.dtype)


def axial_rope_tables(seq_len):
    rows = seq_len // GRID_W
    row_id = jnp.repeat(jnp.arange(rows, dtype=jnp.float32), GRID_W)
    col_id = jnp.tile(jnp.arange(GRID_W, dtype=jnp.float32), rows)
    inv_freq = ROPE_THETA ** (-jnp.arange(0, AXIAL_DIM, 2, dtype=jnp.float32) / AXIAL_DIM)
    ang = jnp.concatenate([row_id[:, None] * inv_freq, col_id[:, None] * inv_freq], -1)
    return jnp.cos(ang), jnp.sin(ang)


def apply_axial_rope(x, cos, sin):
    xf = x.astype(jnp.float32)
    xr = xf.reshape(xf.shape[:-1] + (2, 2, AXIAL_DIM // 2))
    x1 = xr[..., 0, :]
    x2 = xr[..., 1, :]
    c = cos.reshape(cos.shape[0], 2, AXIAL_DIM // 2)
    s = sin.reshape(sin.shape[0], 2, AXIAL_DIM // 2)
    out = jnp.stack([x1 * c - x2 * s, x2 * c + x1 * s], axis=-2)
    return out.reshape(x.shape).astype(x.dtype)


def blocked_attention(q, k, v):
    B, G, R, S, D = q.shape
    nb = S // Q_BLOCK
    qb = jnp.moveaxis(q.reshape(B, G, R, nb, Q_BLOCK, D), 3, 0)

    def one_block(qblk):
        s = jnp.einsum('bgrqd,bgkd->bgrqk', qblk, k).astype(jnp.float32) * (HEAD_DIM ** -0.5)
        p = jax.nn.softmax(s, axis=-1)
        return jnp.einsum('bgrqk,bgkd->bgrqd', p.astype(v.dtype), v)

    ob = lax.map(one_block, qb)
    o = jnp.moveaxis(ob, 0, 3).reshape(B, G, R, S, D)
    return o.transpose(0, 3, 1, 2, 4).reshape(B, S, G * R * D)


def gla_direction(q, k, v, log_a, strict):
    B, H, S, DK = q.shape
    DV = v.shape[-1]
    C = GLA_CHUNK
    n = S // C
    q = q.reshape(B, H, n, C, DK)
    k = k.reshape(B, H, n, C, DK)
    v = v.reshape(B, H, n, C, DV)
    b = jnp.cumsum(log_a.reshape(B, H, n, C, DK), axis=3)
    b_last = b[:, :, :, -1:, :]
    q_dec = q * jnp.exp(b)
    k_inv = k * jnp.exp(-b)
    k_end = k * jnp.exp(b_last - b)
    mask = jnp.tril(jnp.ones((C, C), dtype=bool), -1 if strict else 0)
    scores = jnp.where(mask, jnp.einsum('bhnid,bhnjd->bhnij', q_dec, k_inv), 0.0)
    o_intra = jnp.einsum('bhnij,bhnjv->bhniv', scores, v)
    kv = jnp.einsum('bhnjd,bhnjv->bhndv', k_end, v)
    chunk_decay = jnp.exp(b_last[:, :, :, 0, :])

    def step(state, inp):
        dec, kv_c = inp
        return dec[..., None] * state + kv_c, state

    _, s_prev = lax.scan(step, jnp.zeros((B, H, DK, DV), jnp.float32),
                         (jnp.moveaxis(chunk_decay, 2, 0), jnp.moveaxis(kv, 2, 0)))
    s_prev = jnp.moveaxis(s_prev, 0, 2)
    o_inter = jnp.einsum('bhnid,bhndv->bhniv', q_dec, s_prev)
    return (o_intra + o_inter).reshape(B, H, S, DV)


def setup_inputs(seed: int = 0) -> dict:
    key = jax.random.key(seed)
    ks = jax.random.split(key, 18)
    f32 = jnp.float32

    def nrm(k, shape, scale):
        return jax.random.normal(k, shape, f32) * scale

    seg_scale = (1.0, 1.0, DEEPNORM_BETA, 1.0, 1.0, DEEPNORM_BETA, 1.0, 1.0, 1.0)
    col_scale = jnp.concatenate([jnp.full((n,), s, f32) for n, s in zip(PROJ_SIZES, seg_scale)])
    return {
        "x": nrm(ks[0], (BATCH, SEQ, D_MODEL), 1.0),
        "w_in": nrm(ks[1], (DEPTH, D_MODEL, PROJ_WIDTH), D_MODEL ** -0.5) * col_scale,
        "q_norm_g": 1.0 + nrm(ks[2], (DEPTH, HEAD_DIM), 0.02),
        "k_norm_g": 1.0 + nrm(ks[3], (DEPTH, HEAD_DIM), 0.02),
        "gate_up_fwd": nrm(ks[4], (DEPTH, GATE_RANK, GLA_HEADS * GLA_DK), GATE_RANK ** -0.5),
        "gate_bias_fwd": nrm(ks[5], (DEPTH, GLA_HEADS * GLA_DK), 0.1),
        "gate_up_bwd": nrm(ks[6], (DEPTH, GATE_RANK, GLA_HEADS * GLA_DK), GATE_RANK ** -0.5),
        "gate_bias_bwd": nrm(ks[7], (DEPTH, GLA_HEADS * GLA_DK), 0.1),
        "gla_norm_g": 1.0 + nrm(ks[8], (DEPTH, GLA_DV), 0.02),
        "w_out": nrm(ks[9], (DEPTH, MIX_WIDTH, D_MODEL), MIX_WIDTH ** -0.5) * DEEPNORM_BETA,
        "ln1_g": 1.0 + nrm(ks[10], (DEPTH, D_MODEL), 0.02),
        "ln1_b": nrm(ks[11], (DEPTH, D_MODEL), 0.02),
        "w_ffn_gate": nrm(ks[12], (DEPTH, D_MODEL, D_FF), D_MODEL ** -0.5) * DEEPNORM_BETA,
        "w_ffn_up": nrm(ks[13], (DEPTH, D_MODEL, D_FF), D_MODEL ** -0.5) * DEEPNORM_BETA,
        "w_ffn_down": nrm(ks[14], (DEPTH, D_FF, D_MODEL), D_FF ** -0.5) * DEEPNORM_BETA,
        "ln2_g": 1.0 + nrm(ks[15], (DEPTH, D_MODEL), 0.02),
        "ln2_b": nrm(ks[16], (DEPTH, D_MODEL), 0.02),
    }


def reference(x, w_in, q_norm_g, k_norm_g, gate_up_fwd, gate_bias_fwd, gate_up_bwd, gate_bias_bwd,
              gla_norm_g, w_out, ln1_g, ln1_b, w_ffn_gate, w_ffn_up, w_ffn_down, ln2_g, ln2_b):
    B, S, _ = x.shape
    cos, sin = axial_rope_tables(S)

    def to_gla_heads(t, d):
        return t.reshape(B, S, GLA_HEADS, d).transpose(0, 2, 1, 3).astype(jnp.float32)

    def flip(t):
        return jnp.flip(t, axis=2)

    for layer in range(DEPTH):
        proj = jnp.einsum('bsd,de->bse', x, w_in[layer])
        a_q, a_k, a_v, g_q, g_k, g_v, g_out, z_fwd, z_bwd = jnp.split(proj, PROJ_SPLITS, axis=-1)

        a_q = rms_norm(a_q.reshape(B, S, N_KV_HEADS, Q_PER_KV, HEAD_DIM), q_norm_g[layer]).transpose(0, 2, 3, 1, 4)
        a_k = rms_norm(a_k.reshape(B, S, N_KV_HEADS, HEAD_DIM), k_norm_g[layer]).transpose(0, 2, 1, 3)
        a_v = a_v.reshape(B, S, N_KV_HEADS, HEAD_DIM).transpose(0, 2, 1, 3)
        a_q = apply_axial_rope(a_q, cos, sin)
        a_k = apply_axial_rope(a_k, cos, sin)
        attn_out = blocked_attention(a_q, a_k, a_v)

        gq = to_gla_heads(g_q, GLA_DK) * (GLA_DK ** -0.5)
        gk = to_gla_heads(g_k, GLA_DK)
        gv = to_gla_heads(g_v, GLA_DV)
        la_f = to_gla_heads(jax.nn.log_sigmoid(
            (jnp.einsum('bsr,re->bse', z_fwd, gate_up_fwd[layer]) + gate_bias_fwd[layer]).astype(jnp.float32)) / GATE_TAU, GLA_DK)
        la_b = to_gla_heads(jax.nn.log_sigmoid(
            (jnp.einsum('bsr,re->bse', z_bwd, gate_up_bwd[layer]) + gate_bias_bwd[layer]).astype(jnp.float32)) / GATE_TAU, GLA_DK)
        o_f = gla_direction(gq, gk, gv, la_f, False)
        o_b = flip(gla_direction(flip(gq), flip(gk), flip(gv), flip(la_b), True))
        gla_o = (o_f + o_b).transpose(0, 2, 1, 3)
        gla_o = rms_norm(gla_o, gla_norm_g[layer]) * jax.nn.silu(
            g_out.reshape(B, S, GLA_HEADS, GLA_DV).astype(jnp.float32))
        gla_out = gla_o.reshape(B, S, GLA_WIDTH).astype(x.dtype)

        mixed = jnp.einsum('bse,ed->bsd', jnp.concatenate([attn_out, gla_out], axis=-1), w_out[layer])
        x = layer_norm(DEEPNORM_ALPHA * x + mixed, ln1_g[layer], ln1_b[layer])

        hidden = jax.nn.silu(jnp.einsum('bsd,df->bsf', x, w_ffn_gate[layer])) * jnp.einsum('bsd,df->bsf', x, w_ffn_up[layer])
        ffn = jnp.einsum('bsf,fd->bsd', hidden, w_ffn_down[layer])
        x = layer_norm(DEEPNORM_ALPHA * x + ffn, ln2_g[layer], ln2_b[layer])
    return x
```

```cpp
#include <hip/hip_runtime.h>
#include <cstdio>
#include <cstdint>
#include <cmath>

typedef unsigned short bf16_t;
typedef _Float16 f16_t;

constexpr int BATCH = 8, SEQ = 4096, DM = 1024, T = BATCH * SEQ;
constexpr int PROJ_W = 2336, DFF = 2816;
constexpr float ALPHA = 1.189207115002721f;
constexpr float LN_EPS = 1e-5f, RMS_EPS = 1e-6f;
constexpr float C2 = 0.125f * 1.4426950408889634f;

constexpr size_t MiB = 1u << 20;
constexpr size_t WS_Q = 32 * MiB, WS_K = 64 * MiB, WS_V = 72 * MiB, WS_GQ = 80 * MiB, WS_GK = 96 * MiB, WS_GV = 112 * MiB, WS_GG = 144 * MiB,
                 WS_LAF = 176 * MiB, WS_LAB = 192 * MiB, WS_AO = 208 * MiB, WS_XN = 272 * MiB, WS_H = 336 * MiB, WS_END = 512 * MiB;
constexpr size_t WS_PROJ = 208 * MiB;
constexpr size_t WS_OF = 336 * MiB, WS_OB = 400 * MiB;
constexpr size_t WS_MIX = 32 * MiB;

__device__ __forceinline__ float bf2f(bf16_t v) { return __uint_as_float((unsigned)v << 16); }
__device__ __forceinline__ bf16_t f2bf(float f) { unsigned u = __float_as_uint(f); return (bf16_t)((u + 0x7fffu + ((u >> 16) & 1u)) >> 16); }
__device__ __forceinline__ float wave_sum(float v) {
#pragma unroll
    for (int o = 1; o < 64; o <<= 1) v += __shfl_xor(v, o);
    return v;
}
__constant__ float INV_FREQ[16] = {1.0f, 0.5623413324356079f, 0.3162277638912201f, 0.17782793939113617f, 0.10000000149011612f, 0.05623413249850273f,
                                   0.03162277489900589f, 0.017782794311642647f, 0.009999999776482582f, 0.005623413249850273f, 0.003162277629598975f,
                                   0.0017782794311642647f, 0.0010000000474974513f, 0.000562341301701963f, 0.0003162277571391314f, 0.00017782794020604342f};
__device__ __forceinline__ void sincos_d(double a, double& s, double& c) {
    const double k = rint(a * 0.63661977236758134308);
    double r = fma(-k, 1.57079632679489655800e+00, a); r = fma(-k, 6.12323399573676603587e-17, r);
    const double r2 = r * r;
    const double sp = r * (1.0 + r2 * (-1.0 / 6.0 + r2 * (1.0 / 120.0 + r2 * (-1.0 / 5040.0 + r2 * (1.0 / 362880.0 + r2 * (-1.0 / 39916800.0 + r2 * (1.0 / 6227020800.0 + r2 * (-1.0 / 1307674368000.0))))))));
    const double cp = 1.0 + r2 * (-0.5 + r2 * (1.0 / 24.0 + r2 * (-1.0 / 720.0 + r2 * (1.0 / 40320.0 + r2 * (-1.0 / 3628800.0 + r2 * (1.0 / 479001600.0 + r2 * (-1.0 / 87178291200.0 + r2 * (1.0 / 20922789888000.0))))))));
    const int q = ((int)k) & 3;
    s = (q == 0) ? sp : (q == 1) ? cp : (q == 2) ? -sp : -cp;
    c = (q == 0) ? cp : (q == 1) ? -sp : (q == 2) ? -cp : sp;
}
__device__ __forceinline__ float log_sigmoid_f(float v) { return fminf(v, 0.f) - log1pf(expf(-fabsf(v))); }

template <bool A_BF16>
__global__ __launch_bounds__(256) void naive_gemm(const void* A_, int lda, const float* __restrict__ B, int ldb, float* __restrict__ C, int ldc, int N, int K) {
    __shared__ float As[16][68];
    __shared__ float Bs[16][68];
    const int tid = threadIdx.x, tx = tid & 15, ty = tid >> 4;
    const int m0 = blockIdx.y * 64, n0 = blockIdx.x * 64;
    float acc[4][4];
#pragma unroll
    for (int i = 0; i < 4; ++i)
#pragma unroll
        for (int j = 0; j < 4; ++j) acc[i][j] = 0.f;
    for (int k0 = 0; k0 < K; k0 += 16) {
#pragma unroll
        for (int i = 0; i < 4; ++i) {
            const int e = tid + i * 256, r = e >> 4, kk = e & 15;
            float v;
            if (A_BF16) v = bf2f(((const bf16_t*)A_)[(size_t)(m0 + r) * lda + k0 + kk]); else v = ((const float*)A_)[(size_t)(m0 + r) * lda + k0 + kk];
            As[kk][r] = v;
        }
#pragma unroll
        for (int i = 0; i < 4; ++i) {
            const int e = tid + i * 256, kk = e >> 6, cc = e & 63;
            Bs[kk][cc] = (n0 + cc < N) ? B[(size_t)(k0 + kk) * ldb + n0 + cc] : 0.f;
        }
        __syncthreads();
#pragma unroll
        for (int kk = 0; kk < 16; ++kk) {
            float a[4], b[4];
#pragma unroll
            for (int i = 0; i < 4; ++i) { a[i] = As[kk][ty * 4 + i]; b[i] = Bs[kk][tx * 4 + i]; }
#pragma unroll
            for (int i = 0; i < 4; ++i)
#pragma unroll
                for (int j = 0; j < 4; ++j) acc[i][j] = fmaf(a[i], b[j], acc[i][j]);
        }
        __syncthreads();
    }
#pragma unroll
    for (int i = 0; i < 4; ++i)
#pragma unroll
        for (int j = 0; j < 4; ++j) if (n0 + tx * 4 + j < N) C[(size_t)(m0 + ty * 4 + i) * ldc + n0 + tx * 4 + j] = acc[i][j];
}
__global__ __launch_bounds__(256) void naive_gemm_swiglu(const bf16_t* __restrict__ A, int lda, const float* __restrict__ Bg, const float* __restrict__ Bu, int ldb, bf16_t* __restrict__ H, int ldh, int K) {
    __shared__ float As[16][68];
    __shared__ float Gs[16][68];
    __shared__ float Us[16][68];
    const int tid = threadIdx.x, tx = tid & 15, ty = tid >> 4;
    const int m0 = blockIdx.y * 64, n0 = blockIdx.x * 64;
    float ag[4][4], au[4][4];
#pragma unroll
    for (int i = 0; i < 4; ++i)
#pragma unroll
        for (int j = 0; j < 4; ++j) { ag[i][j] = 0.f; au[i][j] = 0.f; }
    for (int k0 = 0; k0 < K; k0 += 16) {
#pragma unroll
        for (int i = 0; i < 4; ++i) { const int e = tid + i * 256, r = e >> 4, kk = e & 15; As[kk][r] = bf2f(A[(size_t)(m0 + r) * lda + k0 + kk]); }
#pragma unroll
        for (int i = 0; i < 4; ++i) { const int e = tid + i * 256, kk = e >> 6, cc = e & 63; Gs[kk][cc] = Bg[(size_t)(k0 + kk) * ldb + n0 + cc]; Us[kk][cc] = Bu[(size_t)(k0 + kk) * ldb + n0 + cc]; }
        __syncthreads();
#pragma unroll
        for (int kk = 0; kk < 16; ++kk) {
            float a[4], g[4], u[4];
#pragma unroll
            for (int i = 0; i < 4; ++i) { a[i] = As[kk][ty * 4 + i]; g[i] = Gs[kk][tx * 4 + i]; u[i] = Us[kk][tx * 4 + i]; }
#pragma unroll
            for (int i = 0; i < 4; ++i)
#pragma unroll
                for (int j = 0; j < 4; ++j) { ag[i][j] = fmaf(a[i], g[j], ag[i][j]); au[i][j] = fmaf(a[i], u[j], au[i][j]); }
        }
        __syncthreads();
    }
#pragma unroll
    for (int i = 0; i < 4; ++i)
#pragma unroll
        for (int j = 0; j < 4; ++j) { const float g = ag[i][j]; H[(size_t)(m0 + ty * 4 + i) * ldh + n0 + tx * 4 + j] = f2bf(g / (1.f + expf(-g)) * au[i][j]); }
}

__global__ __launch_bounds__(256) void naive_proj_epi(const float* __restrict__ PROJ, const float* __restrict__ qg, const float* __restrict__ kg,
                                                      const float* __restrict__ gupf, const float* __restrict__ gbf, const float* __restrict__ gupb, const float* __restrict__ gbb,
                                                      bf16_t* Qb, bf16_t* Kb, bf16_t* Vb, bf16_t* GQ, bf16_t* GK, bf16_t* GV, bf16_t* GG, f16_t* LAF, f16_t* LAB) {
    const int row = blockIdx.x, t = row % SEQ, tid = threadIdx.x, lane = tid & 63, w = tid >> 6;
    const float* p = PROJ + (size_t)row * PROJ_W;
    for (int h = w; h < 10; h += 4) {
        const float x = p[h * 64 + lane];
        const float ss = wave_sum(x * x);
        const float g = (h < 8 ? qg : kg)[lane];
        const float y = x * (1.0f / sqrtf(ss * (1.0f / 64.0f) + RMS_EPS)) * g;
        const int axis = lane >> 5, half = (lane >> 4) & 1, f = lane & 15;
        const int pos = axis == 0 ? (t >> 6) : (t & 63);
        const float ang = (float)pos * INV_FREQ[f];
        double sd, cd; sincos_d((double)ang, sd, cd);
        const float c = (float)cd, s = (float)sd;
        const float partner = __shfl_xor(y, 16);
        const float o = half == 0 ? (y * c - partner * s) : (y * c + partner * s);
        if (h < 8) Qb[(size_t)row * 512 + h * 64 + lane] = f2bf(o * C2); else Kb[(size_t)row * 128 + (h - 8) * 64 + lane] = f2bf(o);
    }
    if (tid < 128) Vb[(size_t)row * 128 + tid] = f2bf(p[640 + tid]);
    GQ[(size_t)row * 256 + tid] = f2bf(p[768 + tid] * 0.125f);
    GK[(size_t)row * 256 + tid] = f2bf(p[1024 + tid]);
    for (int i = tid; i < 512; i += 256) { GV[(size_t)row * 512 + i] = f2bf(p[1280 + i]); const float g = p[1792 + i]; GG[(size_t)row * 512 + i] = f2bf(g / (1.f + expf(-g))); }
    float sf = gbf[tid], sb = gbb[tid];
#pragma unroll
    for (int r = 0; r < 16; ++r) { sf = fmaf(p[2304 + r], gupf[r * 256 + tid], sf); sb = fmaf(p[2320 + r], gupb[r * 256 + tid], sb); }
    LAF[(size_t)row * 256 + tid] = (f16_t)(log_sigmoid_f(sf) * (1.0f / 16.0f));
    LAB[(size_t)row * 256 + tid] = (f16_t)(log_sigmoid_f(sb) * (1.0f / 16.0f));
}

__global__ __launch_bounds__(64) void naive_attn(const bf16_t* __restrict__ Qb, const bf16_t* __restrict__ Kb, const bf16_t* __restrict__ Vb, bf16_t* __restrict__ AO) {
    const int qblk = blockIdx.x, hq = blockIdx.y, b = blockIdx.z, g = hq >> 2, lane = threadIdx.x;
    const size_t row = (size_t)b * SEQ + qblk * 64 + lane;
    __shared__ float Ks[32][64];
    __shared__ float Vs[32][64];
    float q[64], o[64];
#pragma unroll
    for (int d = 0; d < 64; ++d) { q[d] = bf2f(Qb[row * 512 + hq * 64 + d]); o[d] = 0.f; }
    float m = -INFINITY, l = 0.f;
    for (int j0 = 0; j0 < SEQ; j0 += 32) {
        __syncthreads();
#pragma unroll 4
        for (int i = 0; i < 32; ++i) {
            const size_t kr = ((size_t)b * SEQ + j0 + i) * 128 + g * 64 + lane;
            Ks[i][lane] = bf2f(Kb[kr]); Vs[i][lane] = bf2f(Vb[kr]);
        }
        __syncthreads();
        for (int kj = 0; kj < 32; ++kj) {
            float s = 0.f;
#pragma unroll
            for (int d = 0; d < 64; ++d) s = fmaf(q[d], Ks[kj][d], s);
            if (s > m) { const float sc = exp2f(m - s); l *= sc;
#pragma unroll
                for (int d = 0; d < 64; ++d) o[d] *= sc;
                m = s; }
            const float p = exp2f(s - m); l += p;
#pragma unroll
            for (int d = 0; d < 64; ++d) o[d] = fmaf(p, Vs[kj][d], o[d]);
        }
    }
    const float rl = 1.0f / l;
#pragma unroll
    for (int d = 0; d < 64; ++d) AO[row * 1024 + hq * 64 + d] = f2bf(o[d] * rl);
}

template <int DIR>
__global__ __launch_bounds__(128) void naive_gla(const bf16_t* __restrict__ GQ, const bf16_t* __restrict__ GK, const bf16_t* __restrict__ GV, const f16_t* __restrict__ LA, float* __restrict__ O) {
    const int bh = blockIdx.x, b = bh >> 2, h = bh & 3, tid = threadIdx.x;
    __shared__ float qs[16][64];
    __shared__ float ks[16][64];
    __shared__ float as[16][64];
    __shared__ float vs[16][128];
    float S[64];
#pragma unroll
    for (int d = 0; d < 64; ++d) S[d] = 0.f;
    for (int c = 0; c < SEQ / 16; ++c) {
        const int tbase = DIR ? (SEQ - 16 * (c + 1)) : 16 * c;
        __syncthreads();
#pragma unroll
        for (int i = 0; i < 8; ++i) {
            const int e = tid + i * 128, tt = e >> 6, d = e & 63; const size_t row = (size_t)b * SEQ + tbase + tt;
            qs[tt][d] = bf2f(GQ[row * 256 + h * 64 + d]); ks[tt][d] = bf2f(GK[row * 256 + h * 64 + d]); as[tt][d] = expf((float)LA[row * 256 + h * 64 + d]);
        }
#pragma unroll
        for (int i = 0; i < 16; ++i) { const size_t row = (size_t)b * SEQ + tbase + i; vs[i][tid] = bf2f(GV[row * 512 + h * 128 + tid]); }
        __syncthreads();
        for (int s = 0; s < 16; ++s) {
            const int tt = DIR ? 15 - s : s; const size_t row = (size_t)b * SEQ + tbase + tt;
            const float v = vs[tt][tid];
            float o = 0.f;
            if (DIR == 0) {
#pragma unroll
                for (int d = 0; d < 64; ++d) { S[d] = fmaf(as[tt][d], S[d], ks[tt][d] * v); o = fmaf(qs[tt][d], S[d], o); }
            } else {
#pragma unroll
                for (int d = 0; d < 64; ++d) { const float sp = as[tt][d] * S[d]; o = fmaf(qs[tt][d], sp, o); S[d] = fmaf(ks[tt][d], v, sp); }
            }
            O[row * 512 + h * 128 + tid] = o;
        }
    }
}
__global__ __launch_bounds__(256) void naive_gla_finish(const float* __restrict__ OF, const float* __restrict__ OB, const bf16_t* __restrict__ GG, const float* __restrict__ gn, bf16_t* __restrict__ AO) {
    const int w = threadIdx.x >> 6, lane = threadIdx.x & 63;
    const size_t rh = (size_t)blockIdx.x * 4 + w; const size_t row = rh >> 2; const int h = (int)(rh & 3);
    const size_t base = row * 512 + h * 128;
    const float o0 = OF[base + lane] + OB[base + lane], o1 = OF[base + 64 + lane] + OB[base + 64 + lane];
    const float ss = wave_sum(o0 * o0 + o1 * o1);
    const float r = 1.0f / sqrtf(ss * (1.0f / 128.0f) + RMS_EPS);
    AO[row * 1024 + 512 + h * 128 + lane] = f2bf(o0 * r * gn[lane] * bf2f(GG[base + lane]));
    AO[row * 1024 + 512 + h * 128 + 64 + lane] = f2bf(o1 * r * gn[64 + lane] * bf2f(GG[base + 64 + lane]));
}
__global__ __launch_bounds__(256) void naive_ln(const float* base, const float* __restrict__ add, const float* __restrict__ g, const float* __restrict__ bb, float* out, bf16_t* outb) {
    const int w = threadIdx.x >> 6, lane = threadIdx.x & 63;
    const size_t row = (size_t)blockIdx.x * 4 + w;
    float v[16]; float s = 0.f;
#pragma unroll
    for (int j = 0; j < 16; ++j) { const int c = j * 64 + lane; v[j] = ALPHA * base[row * DM + c] + add[row * DM + c]; s += v[j]; }
    const float mean = wave_sum(s) * (1.0f / DM); float q = 0.f;
#pragma unroll
    for (int j = 0; j < 16; ++j) { v[j] -= mean; q += v[j] * v[j]; }
    const float rstd = 1.0f / sqrtf(wave_sum(q) * (1.0f / DM) + LN_EPS);
#pragma unroll
    for (int j = 0; j < 16; ++j) { const int c = j * 64 + lane; const float y = v[j] * rstd * g[c] + bb[c]; out[row * DM + c] = y; if (outb) outb[row * DM + c] = f2bf(y); }
}

extern "C" void kernel_launch(void* const* d_in, const int* in_sizes, int n_in, void* d_out, int out_size, void* d_ws, size_t ws_size, hipStream_t stream) {
    if (n_in != 17 || in_sizes[0] != T * DM || out_size != T * DM || ws_size < WS_END) { fprintf(stderr, "kernel_launch: unexpected shapes (n_in %d, in0 %d, out %d, ws %zu)\n", n_in, n_in > 0 ? in_sizes[0] : -1, out_size, ws_size); return; }
    const float* x = (const float*)d_in[0]; const float* w_in = (const float*)d_in[1]; const float* qg = (const float*)d_in[2]; const float* kg = (const float*)d_in[3];
    const float* gupf = (const float*)d_in[4]; const float* gbf = (const float*)d_in[5]; const float* gupb = (const float*)d_in[6]; const float* gbb = (const float*)d_in[7];
    const float* gn = (const float*)d_in[8]; const float* w_out = (const float*)d_in[9]; const float* ln1g = (const float*)d_in[10]; const float* ln1b = (const float*)d_in[11];
    const float* wg = (const float*)d_in[12]; const float* wu = (const float*)d_in[13]; const float* wd = (const float*)d_in[14]; const float* ln2g = (const float*)d_in[15]; const float* ln2b = (const float*)d_in[16];
    unsigned char* ws = (unsigned char*)d_ws; float* out = (float*)d_out;
    bf16_t *Qb = (bf16_t*)(ws + WS_Q), *Kb = (bf16_t*)(ws + WS_K), *Vb = (bf16_t*)(ws + WS_V), *GQ = (bf16_t*)(ws + WS_GQ), *GK = (bf16_t*)(ws + WS_GK), *GV = (bf16_t*)(ws + WS_GV), *GG = (bf16_t*)(ws + WS_GG);
    f16_t *LAF = (f16_t*)(ws + WS_LAF), *LAB = (f16_t*)(ws + WS_LAB);
    bf16_t *AO = (bf16_t*)(ws + WS_AO), *XN = (bf16_t*)(ws + WS_XN), *Hb = (bf16_t*)(ws + WS_H);
    float *PROJ = (float*)(ws + WS_PROJ), *OF = (float*)(ws + WS_OF), *OB = (float*)(ws + WS_OB), *MIX = (float*)(ws + WS_MIX);

    naive_gemm<false><<<dim3((PROJ_W + 63) / 64, T / 64), 256, 0, stream>>>(x, DM, w_in, PROJ_W, PROJ, PROJ_W, PROJ_W, DM);
    naive_proj_epi<<<T, 256, 0, stream>>>(PROJ, qg, kg, gupf, gbf, gupb, gbb, Qb, Kb, Vb, GQ, GK, GV, GG, LAF, LAB);
    naive_attn<<<dim3(SEQ / 64, 8, BATCH), 64, 0, stream>>>(Qb, Kb, Vb, AO);
    naive_gla<0><<<BATCH * 4, 128, 0, stream>>>(GQ, GK, GV, LAF, OF);
    naive_gla<1><<<BATCH * 4, 128, 0, stream>>>(GQ, GK, GV, LAB, OB);
    naive_gla_finish<<<T, 256, 0, stream>>>(OF, OB, GG, gn, AO);
    naive_gemm<true><<<dim3(DM / 64, T / 64), 256, 0, stream>>>(AO, DM, w_out, DM, MIX, DM, DM, DM);
    naive_ln<<<T / 4, 256, 0, stream>>>(x, MIX, ln1g, ln1b, out, XN);
    naive_gemm_swiglu<<<dim3(DFF / 64, T / 64), 256, 0, stream>>>(XN, DM, wg, wu, DFF, Hb, DFF, DM);
    naive_gemm<true><<<dim3(DM / 64, T / 64), 256, 0, stream>>>(Hb, DFF, wd, DM, MIX, DM, DM, DFF);
    naive_ln<<<T / 4, 256, 0, stream>>>(out, MIX, ln2g, ln2b, out, nullptr);
}
```
